# Optimizing an MI355X kernel written in HIP

```python
import math
import jax, jax.numpy as jnp
from jax import lax
import numpy as np

D_MODEL = 1024
BATCH = 16
SEQ = 2048
DEPTH = 1

HEAD_DIM = 64
ATTN_GROUPS = ((128, 1), (512, 4), (2048, 16))
ATTN_WIDTH = 3 * D_MODEL // 4
N_ATTN_HEADS = ATTN_WIDTH // HEAD_DIM
HEADS_PER_GROUP = N_ATTN_HEADS // len(ATTN_GROUPS)
ATTN_OUT_WIDTH = HEADS_PER_GROUP * HEAD_DIM
FOURIER_WIDTH = D_MODEL // 4
FOURIER_GROUPS = 4
FOURIER_GROUP_DIM = FOURIER_WIDTH // FOURIER_GROUPS
ROPE_THETA = 500000.0
ROPE_DIM = HEAD_DIM // 4
MEM_LEN = 256
CROSS_HEADS = 4
CROSS_HEAD_DIM = D_MODEL // CROSS_HEADS
D_FF = 4 * D_MODEL
QUERY_BLOCK = 64
EPS = 1e-6
IN_WIDTH = FOURIER_WIDTH + 3 * ATTN_WIDTH + 2 * D_MODEL
NEG_BIG = -1e30

kernel_name = 'hybrid_fourier_dilated_encoder_block'


def rms_norm(x, g):
    xf = x.astype(jnp.float32)
    y = xf * lax.rsqrt(jnp.mean(xf * xf, axis=-1, keepdims=True) + EPS)
    return (y * g.astype(jnp.float32)).astype(x.dtype)


def partial_rope(t):
    S = t.shape[1]
    half = ROPE_DIM // 2
    inv_freq = ROPE_THETA ** (-jnp.arange(half, dtype=jnp.float32) / half)
    ang = jnp.arange(S, dtype=jnp.float32)[:, None] * inv_freq[None, :]
    cos = jnp.cos(ang)[None, :, None, :]
    sin = jnp.sin(ang)[None, :, None, :]
    tr = t[..., :ROPE_DIM].astype(jnp.float32)
    t1, t2 = tr[..., :half], tr[..., half:]
    rot = jnp.concatenate([t1 * cos - t2 * sin, t1 * sin + t2 * cos], axis=-1).astype(t.dtype)
    return jnp.concatenate([rot, t[..., ROPE_DIM:]], axis=-1)


def dilated_window_attention(q, k, v, window, dilation):
    B, S, H, Dh = q.shape
    L = S // dilation
    reach = window // (2 * dilation)
    qb = math.gcd(L, QUERY_BLOCK)
    nblk = L // qb
    kw = qb + 2 * reach

    def stride_split(t):
        return t.reshape(B, L, dilation, H, Dh).transpose(0, 3, 2, 1, 4)

    qs, ks, vs = stride_split(q), stride_split(k), stride_split(v)
    pad = ((0, 0), (0, 0), (0, 0), (reach, reach), (0, 0))
    kp = jnp.pad(ks, pad)
    vp = jnp.pad(vs, pad)
    key_idx = jnp.arange(nblk)[:, None] * qb + jnp.arange(kw)[None, :]
    kb = kp[:, :, :, key_idx].astype(jnp.float32)
    vb = vp[:, :, :, key_idx].astype(jnp.float32)
    qblk = qs.reshape(B, H, dilation, nblk, qb, Dh).astype(jnp.float32)
    s = jnp.einsum('bhrnqe,bhrnke->bhrnqk', qblk, kb) * (Dh ** -0.5)
    qpos = jnp.arange(nblk)[:, None] * qb + jnp.arange(qb)[None, :]
    kpos = key_idx - reach
    rel = kpos[:, None, :] - qpos[:, :, None]
    valid = (jnp.abs(rel) <= reach) & (kpos[:, None, :] >= 0) & (kpos[:, None, :] < L)
    s = jnp.where(valid, s, NEG_BIG)
    m = jnp.max(s, axis=-1, keepdims=True)
    p = jnp.exp(s - m)
    denom = jnp.sum(p, axis=-1, keepdims=True)
    o = jnp.einsum('bhrnqk,bhrnke->bhrnqe', p / denom, vb)
    lse = (m + jnp.log(denom))[..., 0]
    o = o.reshape(B, H, dilation, L, Dh).transpose(0, 3, 2, 1, 4).reshape(B, S, H, Dh)
    lse = lse.reshape(B, H, dilation, L).transpose(0, 3, 2, 1).reshape(B, S, H)
    return o, lse


def hybrid_mixer(h, w_in, fourier_mix, w_fourier_branch, w_attn_branch, w_mix_out):
    B, S, _ = h.shape
    proj = h @ w_in
    c0 = FOURIER_WIDTH
    c1 = c0 + ATTN_WIDTH
    c2 = c1 + ATTN_WIDTH
    c3 = c2 + ATTN_WIDTH
    c4 = c3 + D_MODEL
    u, q, k, v, g_f, g_a = jnp.split(proj, [c0, c1, c2, c3, c4], axis=-1)

    uf = u.reshape(B, S, FOURIER_GROUPS, FOURIER_GROUP_DIM).astype(jnp.float32)
    spec = jnp.fft.fft2(uf, axes=(1, 3), norm='ortho').real.astype(h.dtype)
    y_f = jnp.einsum('bsgc,gcd->bsgd', spec, fourier_mix).reshape(B, S, FOURIER_WIDTH)

    q = partial_rope(q.reshape(B, S, N_ATTN_HEADS, HEAD_DIM))
    k = partial_rope(k.reshape(B, S, N_ATTN_HEADS, HEAD_DIM))
    v = v.reshape(B, S, N_ATTN_HEADS, HEAD_DIM)
    outs, lses = [], []
    for gi, (window, dilation) in enumerate(ATTN_GROUPS):
        sl = slice(gi * HEADS_PER_GROUP, (gi + 1) * HEADS_PER_GROUP)
        o, lse = dilated_window_attention(q[:, :, sl], k[:, :, sl], v[:, :, sl], window, dilation)
        outs.append(o)
        lses.append(lse)
    o_all = jnp.stack(outs, axis=0)
    lse_all = jnp.stack(lses, axis=0)
    wts = jax.nn.softmax(lse_all, axis=0)
    y_a = jnp.sum(wts[..., None] * o_all, axis=0).astype(h.dtype).reshape(B, S, ATTN_OUT_WIDTH)

    merged = jax.nn.sigmoid(g_f) * (y_f @ w_fourier_branch) + jax.nn.sigmoid(g_a) * (y_a @ w_attn_branch)
    return merged @ w_mix_out


def memory_cross_attention(h, mem_n, w_cq, w_ckv, w_co):
    B, S, _ = h.shape
    M = mem_n.shape[1]
    q = (h @ w_cq).reshape(B, S, CROSS_HEADS, CROSS_HEAD_DIM)
    k, v = jnp.split(mem_n @ w_ckv, 2, axis=-1)
    k = k.reshape(B, M, CROSS_HEADS, CROSS_HEAD_DIM)
    v = v.reshape(B, M, CROSS_HEADS, CROSS_HEAD_DIM)
    s = jnp.einsum('bshe,bmhe->bhsm', q.astype(jnp.float32), k.astype(jnp.float32)) * (CROSS_HEAD_DIM ** -0.5)
    p = jax.nn.softmax(s, axis=-1)
    o = jnp.einsum('bhsm,bmhe->bshe', p, v.astype(jnp.float32)).astype(h.dtype).reshape(B, S, D_MODEL)
    return o @ w_co


def sq_relu_mlp(h, w_up, w_down):
    a = jax.nn.relu(h @ w_up)
    return (a * a) @ w_down


def setup_inputs(seed: int = 0) -> dict:
    key = jax.random.key(seed)
    ks = jax.random.split(key, 20)
    f32 = jnp.float32

    def nrm(k, shape, fan_in):
        return jax.random.normal(k, shape, f32) * (fan_in ** -0.5)

    def gain(k, shape):
        return 1.0 + 0.01 * jax.random.normal(k, shape, f32)

    return {
        'x': jax.random.normal(ks[0], (BATCH, SEQ, D_MODEL), f32),
        'mem': jax.random.normal(ks[1], (BATCH, MEM_LEN, D_MODEL), f32),
        'norm_mix': gain(ks[2], (DEPTH, D_MODEL)),
        'w_in': nrm(ks[3], (DEPTH, D_MODEL, IN_WIDTH), D_MODEL),
        'fourier_mix': nrm(ks[4], (DEPTH, FOURIER_GROUPS, FOURIER_GROUP_DIM, FOURIER_GROUP_DIM), FOURIER_GROUP_DIM),
        'w_fourier_branch': nrm(ks[5], (DEPTH, FOURIER_WIDTH, D_MODEL), FOURIER_WIDTH),
        'w_attn_branch': nrm(ks[6], (DEPTH, ATTN_OUT_WIDTH, D_MODEL), ATTN_OUT_WIDTH),
        'w_mix_out': nrm(ks[7], (DEPTH, D_MODEL, D_MODEL), D_MODEL),
        'norm_cross': gain(ks[8], (DEPTH, D_MODEL)),
        'norm_mem': gain(ks[9], (DEPTH, D_MODEL)),
        'w_cq': nrm(ks[10], (DEPTH, D_MODEL, D_MODEL), D_MODEL),
        'w_ckv': nrm(ks[11], (DEPTH, D_MODEL, 2 * D_MODEL), D_MODEL),
        'w_co': nrm(ks[12], (DEPTH, D_MODEL, D_MODEL), D_MODEL),
        'norm_mlp': gain(ks[13], (DEPTH, D_MODEL)),
        'w_up': nrm(ks[14], (DEPTH, D_MODEL, D_FF), D_MODEL),
        'w_down': nrm(ks[15], (DEPTH, D_FF, D_MODEL), D_FF),
        'norm_final': gain(ks[16], (D_MODEL,)),
    }


def reference(x, mem, norm_mix, w_in, fourier_mix, w_fourier_branch, w_attn_branch, w_mix_out,
              norm_cross, norm_mem, w_cq, w_ckv, w_co, norm_mlp, w_up, w_down, norm_final):
    for l in range(DEPTH):
        h = rms_norm(x, norm_mix[l])
        x = x + hybrid_mixer(h, w_in[l], fourier_mix[l], w_fourier_branch[l], w_attn_branch[l], w_mix_out[l])
        h = rms_norm(x, norm_cross[l])
        mem_n = rms_norm(mem, norm_mem[l])
        x = x + memory_cross_attention(h, mem_n, w_cq[l], w_ckv[l], w_co[l])
        h = rms_norm(x, norm_mlp[l])
        x = x + sq_relu_mlp(h, w_up[l], w_down[l])
    return rms_norm(x, norm_final)
```

```cpp
#include <hip/hip_runtime.h>
#include <cstdio>
#include <cstdint>

#define LAS __attribute__((address_space(3)))
#define GAS __attribute__((address_space(1)))
#define DI __device__ __forceinline__
typedef unsigned short bf16_t;
typedef short bf16x8 __attribute__((ext_vector_type(8)));
typedef short s16x4 __attribute__((ext_vector_type(4)));
typedef float f32x4 __attribute__((ext_vector_type(4)));
typedef float f32x2 __attribute__((ext_vector_type(2)));
typedef float f32x16 __attribute__((ext_vector_type(16)));
typedef unsigned u32x4 __attribute__((ext_vector_type(4)));
typedef unsigned u32x2 __attribute__((ext_vector_type(2)));

#ifndef MK_N_LAUNCHES
#define MK_N_LAUNCHES 13
#endif
#ifndef MK_DEBUG
#define MK_DEBUG 0
#endif

constexpr int T = 32768, DM = 1024, SEQ = 2048, NB = 16, MEMT = 4096, FF = 4096;
constexpr int NQKV = 2304, NGATE = 2048, NIN = NQKV + NGATE  , NPF = 512, WIN_ROWS = NPF + NIN  , INW = 4608;
constexpr float EPS = 1e-6f;
constexpr float LOG2E = 1.4426950408889634f;

constexpr size_t MiB = 1u << 20;
constexpr size_t WS_CTL = 0, CTL_ZERO_BYTES = 1 * MiB;
constexpr size_t WS_SS = 256 * 1024;
constexpr size_t WS_ROPEC = 1 * MiB, WS_ROPES = WS_ROPEC + 65536, WS_LROW = WS_ROPEC + 131072;
constexpr size_t WS_WIN = 2 * MiB;
constexpr size_t WS_WFB = 12 * MiB, WS_WAB = WS_WFB + 512 * 1024;
constexpr size_t WS_WMIX = 13 * MiB, WS_WCQ = 15 * MiB, WS_WCKV = 17 * MiB, WS_WCO = 21 * MiB, WS_WUP = 23 * MiB, WS_WDN = 31 * MiB;
constexpr size_t WS_CCAT = 40 * MiB;
constexpr size_t WS_MEMN = 56 * MiB;
constexpr size_t WS_XN = 64 * MiB;
constexpr size_t WS_X1 = 64 * MiB;
constexpr size_t WS_YFA = 128 * MiB;
constexpr size_t WS_X2 = 128 * MiB;
constexpr size_t WS_QKV = 192 * MiB;
constexpr size_t WS_TMP = 192 * MiB, WS_MERGED = 256 * MiB, WS_QC = 192 * MiB, WS_PB = 256 * MiB, WS_O = 320 * MiB;
constexpr size_t WS_GATES = 336 * MiB;
constexpr size_t WS_PT = 464 * MiB;
constexpr size_t WS_KC = 496 * MiB, WS_VCT = 504 * MiB;
constexpr size_t WS_HID = 192 * MiB;
constexpr size_t WS_END = 512 * MiB;
constexpr int CW_TMO = 0, CW_CODE = 1, CW_BAR = 4096;

constexpr int RING_BYTES = 131072;
constexpr int XLDS_OFF = RING_BYTES;
constexpr int LDSCTL_OFF = RING_BYTES + 12288, MISC_OFF = LDSCTL_OFF + 320;
constexpr int LDS_BYTES = 147456;
constexpr int NWAVES = 8;

DI unsigned f2bf(float f) { unsigned u = __builtin_bit_cast(unsigned, f); return (u + 0x7fffu + ((u >> 16) & 1u)) >> 16; }
DI unsigned pk2(float lo, float hi) { return f2bf(lo) | (f2bf(hi) << 16); }
DI float bflo(unsigned w) { return __builtin_bit_cast(float, w << 16); }
DI float bfhi(unsigned w) { return __builtin_bit_cast(float, w & 0xffff0000u); }
DI unsigned cvt_pk_bf16(float lo, float hi) { unsigned r; asm volatile("v_cvt_pk_bf16_f32 %0, %1, %2" : "=v"(r) : "v"(lo), "v"(hi)); return r; }
DI float wave_sum(float v) {
#pragma unroll
    for (int o = 1; o < 64; o <<= 1) v += __shfl_xor(v, o);
    return v;
}
DI int lane_id() { int l = (int)__builtin_amdgcn_mbcnt_hi(~0u, __builtin_amdgcn_mbcnt_lo(~0u, 0u)); asm volatile("" : "+v"(l)); return l; }
#define LDS_WAIT() asm volatile("s_waitcnt lgkmcnt(0)" ::: "memory")
#define VM_WAIT() asm volatile("s_waitcnt vmcnt(0)" ::: "memory")

namespace pg8 {
constexpr int BM = 256, BK = 64, HALF = 128, HTB = HALF * BK * 2, STAGE_BYTES = 8 * HTB, NXCD = 8, WGM = 8;
__host__ __device__ __forceinline__ int lds_byte(int r, int c) { const int st = (r >> 4) * 2 + (c >> 5), rr = r & 15, cc = c & 31, ob = rr * 64 + cc * 2; return st * 1024 + (ob ^ (((ob >> 9) & 1) << 5)); }
__host__ __device__ __forceinline__ void stage_rc(int b, int& R, int& C) { const int st = b / 1024, sb = b % 1024, swz = sb ^ (((sb >> 9) & 1) << 5); R = (st >> 1) * 16 + swz / 64; C = (st & 1) * 32 + (swz % 64) / 2; }
__host__ __device__ __forceinline__ int perm32(int rho) { const int n = rho >> 4, i = rho & 15; return 8 * (i >> 2) + 4 * n + (i & 3); }

struct Unit { int pm, pn; const char* a; const char* b; };

struct TileOrder {
    int nM, nN, nwg, G, c;
    DI void init(int nM_, int nN_, int G_, int c_) { nM = nM_; nN = nN_; nwg = nM * nN; G = G_; c = c_; }
    DI bool tile(int i, int& pm, int& pn) const {
        const long L = (long)i * G + c; if (L >= nwg) return false;
        int wgid = (int)L; { const int q = nwg / NXCD, r = nwg % NXCD, xcd = wgid % NXCD, off = wgid / NXCD; wgid = (xcd < r ? xcd * (q + 1) : r * (q + 1) + (xcd - r) * q) + off; }
        const int nig = WGM * nN, gid = wgid / nig, fm = gid * WGM, gsz = (nM - fm) < WGM ? (nM - fm) : WGM;
        pm = fm + ((wgid % nig) % gsz); pn = (wgid % nig) / gsz; return true;
    }
};

template <class Epi, class Sched, bool ALIGN_EPI>
DI void gemm_phase(LAS unsigned char* lds, LAS unsigned char* xlds, const int K, const int lda, const int ldb, const Sched& S, const Epi& E) {
    const int tid = threadIdx.x, wid = __builtin_amdgcn_readfirstlane(tid >> 6), lane = tid & 63, wr = wid >> 2, wc = wid & 3, fr = lane & 15, fq = lane >> 4;
    const int nt = K / BK;
    unsigned voffA[2], voffB[2];
#pragma unroll
    for (int i = 0; i < 2; ++i) { int R, C; stage_rc(tid * 16 + i * 8192, R, C); const int Rb = Epi::PERM ? ((R & ~31) + perm32(R & 31)) : R;
        voffA[i] = (unsigned)(R * lda + C) * 2u; voffB[i] = (unsigned)(Rb * ldb + C) * 2u; }
    const size_t kstep = (size_t)(BK * 2);
    const size_t hstepA = (size_t)HALF * lda * 2, hstepB = (size_t)HALF * ldb * 2;
    const unsigned ldsw = (unsigned)wid * 1024u;
    const int aoff = lds_byte(wr * 64 + fr, fq * 8), boff = lds_byte(wc * 32 + fr, fq * 8);
#define PG8_SA(b, h) (((b) * 2 + (h)) * HTB)
#define PG8_SB(b, h) ((4 + (b) * 2 + (h)) * HTB)
#define PG8_STAGE(bufoff, gbase, voff) do { _Pragma("unroll") for (int _i = 0; _i < 2; ++_i) \
        __builtin_amdgcn_global_load_lds((const unsigned*)((const char*)(gbase) + (voff)[_i]), (LAS unsigned*)(lds + (bufoff) + ldsw + _i * 8192), 16, 0, 0); } while (0)
#define PG8_LDA(dst, b, h) do { _Pragma("unroll") for (int m = 0; m < 4; ++m) _Pragma("unroll") for (int k = 0; k < 2; ++k) dst[m][k] = *(const LAS bf16x8*)(lds + PG8_SA(b, h) + aoff + m * 2048 + k * 1024); } while (0)
#define PG8_LDB(dst, b, h) do { _Pragma("unroll") for (int n = 0; n < 2; ++n) _Pragma("unroll") for (int k = 0; k < 2; ++k) dst[n][k] = *(const LAS bf16x8*)(lds + PG8_SB(b, h) + boff + n * 2048 + k * 1024); } while (0)
#define PG8_MMA(ai, bj, At, Bt) do { __builtin_amdgcn_s_setprio(1); _Pragma("unroll") for (int m = 0; m < 4; ++m) _Pragma("unroll") for (int n = 0; n < 2; ++n) _Pragma("unroll") for (int k = 0; k < 2; ++k) \
        acc[ai][bj][m][n] = __builtin_amdgcn_mfma_f32_16x16x32_bf16(Bt[n][k], At[m][k], acc[ai][bj][m][n], 0, 0, 0); __builtin_amdgcn_s_setprio(0); } while (0)
#define PG8_WAIT_V(n) asm volatile("s_waitcnt vmcnt(" #n ")" ::: "memory")
#define PG8_WAIT_L(n) asm volatile("s_waitcnt lgkmcnt(" #n ")" ::: "memory")
#define PG8_BAR __builtin_amdgcn_s_barrier()
#define PG8_SCHED __builtin_amdgcn_sched_barrier(0)
    Unit cur, nxt; int ui = 0;
    if (!S.next(0, cur)) return;
    f32x4 acc[2][2][4][2];
#pragma unroll
    for (int a = 0; a < 2; ++a)
#pragma unroll
        for (int b = 0; b < 2; ++b)
#pragma unroll
            for (int m = 0; m < 4; ++m)
#pragma unroll
                for (int n = 0; n < 2; ++n) acc[a][b][m][n] = (f32x4){0.f, 0.f, 0.f, 0.f};
    bf16x8 At[4][2], B0[2][2], B1[2][2];
    const char* cA = cur.a; const char* cB = cur.b;
    PG8_STAGE(PG8_SB(0, 0), cB, voffB); PG8_STAGE(PG8_SB(0, 1), cB + hstepB, voffB); PG8_STAGE(PG8_SA(0, 0), cA, voffA); PG8_STAGE(PG8_SA(0, 1), cA + hstepA, voffA);
    if (wr == 1) PG8_BAR;
    PG8_WAIT_V(2); PG8_BAR;
    PG8_STAGE(PG8_SB(1, 0), cB + kstep, voffB); PG8_STAGE(PG8_SA(1, 0), cA + kstep, voffA); PG8_STAGE(PG8_SB(1, 1), cB + hstepB + kstep, voffB);
    PG8_WAIT_V(6); PG8_BAR;
    for (;;) {
        const bool has_next = S.next(ui + 1, nxt);
        const char* nA = has_next ? nxt.a : cA; const char* nB = has_next ? nxt.b : cB;
        for (int t = 0; t < nt; t += 2) {
            const bool last = (t == nt - 2);
            const char* a1 = cA + (size_t)(t + 1) * kstep;
            const char* a2 = last ? nA : cA + (size_t)(t + 2) * kstep; const char* b2 = last ? nB : cB + (size_t)(t + 2) * kstep;
            const char* a3 = a2 + kstep; const char* b3 = b2 + kstep;
            PG8_LDB(B0, 0, 0); PG8_LDB(B1, 0, 1); PG8_SCHED; PG8_LDA(At, 0, 0); PG8_STAGE(PG8_SA(1, 1), a1 + hstepA, voffA);
            PG8_WAIT_V(8); PG8_WAIT_L(0); PG8_BAR; PG8_MMA(0, 0, At, B0); PG8_MMA(0, 1, At, B1); PG8_BAR; PG8_SCHED;
            PG8_LDA(At, 0, 1); PG8_STAGE(PG8_SB(0, 0), b2, voffB); PG8_STAGE(PG8_SB(0, 1), b2 + hstepB, voffB); PG8_STAGE(PG8_SA(0, 0), a2, voffA);
            PG8_WAIT_V(8); PG8_WAIT_L(0); PG8_BAR; PG8_MMA(1, 0, At, B0); PG8_MMA(1, 1, At, B1); PG8_BAR; PG8_SCHED;
            PG8_LDB(B0, 1, 0); PG8_LDB(B1, 1, 1); PG8_SCHED; PG8_LDA(At, 1, 0); PG8_STAGE(PG8_SA(0, 1), a2 + hstepA, voffA);
            PG8_WAIT_V(8); PG8_WAIT_L(0); PG8_BAR; PG8_MMA(0, 0, At, B0); PG8_MMA(0, 1, At, B1); PG8_BAR; PG8_SCHED;
            PG8_LDA(At, 1, 1); PG8_STAGE(PG8_SB(1, 0), b3, voffB); PG8_STAGE(PG8_SB(1, 1), b3 + hstepB, voffB); PG8_STAGE(PG8_SA(1, 0), a3, voffA);
            PG8_WAIT_V(8); PG8_WAIT_L(0); PG8_BAR; PG8_MMA(1, 0, At, B0); PG8_MMA(1, 1, At, B1); PG8_BAR; PG8_SCHED;
        }
        if constexpr (ALIGN_EPI) { if (wr == 0) PG8_BAR; }
        E(acc, cur, wr, wc, fr, fq, xlds);
        if (!has_next) break;
#pragma unroll
        for (int a = 0; a < 2; ++a)
#pragma unroll
            for (int b = 0; b < 2; ++b)
#pragma unroll
                for (int m = 0; m < 4; ++m)
#pragma unroll
                    for (int n = 0; n < 2; ++n) acc[a][b][m][n] = (f32x4){0.f, 0.f, 0.f, 0.f};
        cur = nxt; cA = nA; cB = nB; ++ui;
        if constexpr (ALIGN_EPI) { if (wr == 1) PG8_BAR; }
    }
    PG8_WAIT_V(0);
    if constexpr (!ALIGN_EPI) { if (wr == 0) PG8_BAR; }
    PG8_BAR;
#undef PG8_SA
#undef PG8_SB
#undef PG8_STAGE
#undef PG8_LDA
#undef PG8_LDB
#undef PG8_MMA
#undef PG8_WAIT_V
#undef PG8_WAIT_L
#undef PG8_BAR
#undef PG8_SCHED
}
}
using pg8::Unit;
typedef const f32x4 (&AccRef)[2][2][4][2];

struct SchedPlain {
    pg8::TileOrder o; const char* A; const char* B; size_t astep, bstep;
    DI void init(const void* A_, int lda, const void* B_, int ldb, int nM, int nN, int G, int c) { o.init(nM, nN, G, c); A = (const char*)A_; B = (const char*)B_; astep = (size_t)256 * lda * 2; bstep = (size_t)256 * ldb * 2; }
    DI bool next(int i, Unit& u) const { if (!o.tile(i, u.pm, u.pn)) return false; u.a = A + u.pm * astep; u.b = B + u.pn * bstep; return true; }
};
struct SchedDft {
    const char* A; const char* B; int c;
    DI bool next(int i, Unit& u) const { if (i > 0 || c >= 128) return false; u.pm = c; u.pn = 0; u.a = A + (size_t)(c & 7) * 256 * 4096 * 2; u.b = B + (size_t)(c >> 3) * 256 * 4096 * 2; return true; }
};
struct SchedXS {
    pg8::TileOrder o; const char* QC; const char* KC;
    DI bool next(int i, Unit& u) const { if (!o.tile(i, u.pm, u.pn)) return false; u.a = QC + ((size_t)u.pm * 256 * 1024 + u.pn * 256) * 2; u.b = KC + ((size_t)(u.pm >> 3) * 256 * 1024 + u.pn * 256) * 2; return true; }
};
struct SchedXV {
    pg8::TileOrder o; const char* PB; const char* VT;
    DI bool next(int i, Unit& u) const { if (!o.tile(i, u.pm, u.pn)) return false; u.a = PB + ((size_t)u.pm * 256 * 1024 + u.pn * 256) * 2; u.b = VT + ((size_t)u.pn * 256 * 4096 + (u.pm >> 3) * 256) * 2; return true; }
};

struct EpiIn {
    static constexpr bool PERM = true;
    bf16_t* qkv; bf16_t* gates; const float* ropec; const float* ropes;
    DI void operator()(AccRef acc, const Unit& u, int wr, int wc, int fr, int fq, LAS unsigned char*) const {
        const int pn = u.pn;
        const bool isg = pn >= 9;
        const bool rope = (pn < 6) && ((wc & 1) == 0);
#pragma unroll
        for (int ai = 0; ai < 2; ++ai)
#pragma unroll
            for (int m = 0; m < 4; ++m) {
                const int row = u.pm * 256 + ai * 128 + wr * 64 + m * 16 + fr;
                f32x4 c0, c1, s0, s1;
                if (rope) { const int pos = row & (SEQ - 1); c0 = *(const f32x4*)(ropec + pos * 8); c1 = *(const f32x4*)(ropec + pos * 8 + 4); s0 = *(const f32x4*)(ropes + pos * 8); s1 = *(const f32x4*)(ropes + pos * 8 + 4); }
#pragma unroll
                for (int bj = 0; bj < 2; ++bj) {
                    f32x4 v0 = acc[ai][bj][m][0], v1 = acc[ai][bj][m][1];
                    if (rope) {
                        f32x4 p0, p1;
#pragma unroll
                        for (int e = 0; e < 4; ++e) { p0[e] = __shfl_xor(v0[e], 16); p1[e] = __shfl_xor(v1[e], 16); }
                        if (fq == 0) { v0 = v0 * c0 - p0 * s0; v1 = v1 * c1 - p1 * s1; }
                        else if (fq == 1) { v0 = p0 * s0 + v0 * c0; v1 = p1 * s1 + v1 * c1; }
                    }
                    if (isg) {
#pragma unroll
                        for (int e = 0; e < 4; ++e) { v0[e] = 1.0f / (1.0f + __expf(-v0[e])); v1[e] = 1.0f / (1.0f + __expf(-v1[e])); }
                    }
                    u32x4 w; w.x = cvt_pk_bf16(v0[0], v0[1]); w.y = cvt_pk_bf16(v0[2], v0[3]); w.z = cvt_pk_bf16(v1[0], v1[1]); w.w = cvt_pk_bf16(v1[2], v1[3]);
                    const int colt = bj * 128 + wc * 32 + 8 * fq;
                    bf16_t* dst = isg ? gates + (size_t)row * NGATE + (pn - 9) * 256 + colt : qkv + (size_t)row * NQKV + pn * 256 + colt;
                    *(u32x4*)dst = w;
                }
            }
    }
};
struct EpiPt {
    static constexpr bool PERM = true;
    bf16_t* pt;
    DI void operator()(AccRef acc, const Unit& u, int wr, int wc, int fr, int fq, LAS unsigned char*) const {
        const int part = u.pm, b = u.pn >> 3, s0 = (u.pn & 7) * 256;
#pragma unroll
        for (int ai = 0; ai < 2; ++ai)
#pragma unroll
            for (int m = 0; m < 4; ++m) {
                const int gd = ai * 128 + wr * 64 + m * 16 + fr;
                bf16_t* rowp = pt + ((size_t)(b * 256 + gd) * 4096 + part * 2048 + s0);
#pragma unroll
                for (int bj = 0; bj < 2; ++bj) {
                    const f32x4 v0 = acc[ai][bj][m][0], v1 = acc[ai][bj][m][1];
                    u32x4 w; w.x = cvt_pk_bf16(v0[0], v0[1]); w.y = cvt_pk_bf16(v0[2], v0[3]); w.z = cvt_pk_bf16(v1[0], v1[1]); w.w = cvt_pk_bf16(v1[2], v1[3]);
                    *(u32x4*)(rowp + bj * 128 + wc * 32 + 8 * fq) = w;
                }
            }
    }
};
struct EpiPlain {
    static constexpr bool PERM = true;
    bf16_t* O; int ldc;
    DI void operator()(AccRef acc, const Unit& u, int wr, int wc, int fr, int fq, LAS unsigned char*) const {
#pragma unroll
        for (int ai = 0; ai < 2; ++ai)
#pragma unroll
            for (int m = 0; m < 4; ++m) {
                const int row = u.pm * 256 + ai * 128 + wr * 64 + m * 16 + fr;
                bf16_t* rowp = O + (size_t)row * ldc + u.pn * 256 + wc * 32 + 8 * fq;
#pragma unroll
                for (int bj = 0; bj < 2; ++bj) {
                    const f32x4 v0 = acc[ai][bj][m][0], v1 = acc[ai][bj][m][1];
                    u32x4 w; w.x = cvt_pk_bf16(v0[0], v0[1]); w.y = cvt_pk_bf16(v0[2], v0[3]); w.z = cvt_pk_bf16(v1[0], v1[1]); w.w = cvt_pk_bf16(v1[2], v1[3]);
                    *(u32x4*)(rowp + bj * 128) = w;
                }
            }
    }
};
template <int MODE> struct EpiGate {
    static constexpr bool PERM = true;
    bf16_t* O; const bf16_t* prev; const bf16_t* gates; int goff;
    DI void operator()(AccRef acc, const Unit& u, int wr, int wc, int fr, int fq, LAS unsigned char*) const {
#pragma unroll
        for (int ai = 0; ai < 2; ++ai)
#pragma unroll
            for (int m = 0; m < 4; ++m) {
                const int row = u.pm * 256 + ai * 128 + wr * 64 + m * 16 + fr;
                const int col = u.pn * 256 + wc * 32 + 8 * fq;
#pragma unroll
                for (int bj = 0; bj < 2; ++bj) {
                    f32x4 v0 = acc[ai][bj][m][0], v1 = acc[ai][bj][m][1];
                    const u32x4 g = *(const u32x4*)(gates + (size_t)row * NGATE + goff + col + bj * 128);
                    v0[0] *= bflo(g.x); v0[1] *= bfhi(g.x); v0[2] *= bflo(g.y); v0[3] *= bfhi(g.y); v1[0] *= bflo(g.z); v1[1] *= bfhi(g.z); v1[2] *= bflo(g.w); v1[3] *= bfhi(g.w);
                    if (MODE == 1) { const u32x4 p = *(const u32x4*)(prev + (size_t)row * DM + col + bj * 128);
                        v0[0] += bflo(p.x); v0[1] += bfhi(p.x); v0[2] += bflo(p.y); v0[3] += bfhi(p.y); v1[0] += bflo(p.z); v1[1] += bfhi(p.z); v1[2] += bflo(p.w); v1[3] += bfhi(p.w); }
                    u32x4 w; w.x = cvt_pk_bf16(v0[0], v0[1]); w.y = cvt_pk_bf16(v0[2], v0[3]); w.z = cvt_pk_bf16(v1[0], v1[1]); w.w = cvt_pk_bf16(v1[2], v1[3]);
                    *(u32x4*)(O + (size_t)row * DM + col + bj * 128) = w;
                }
            }
    }
};
struct EpiRes {
    static constexpr bool PERM = false;
    const float* base; float* out; bf16_t* xb; float* ss;
    DI void operator()(AccRef acc, const Unit& u, int wr, int wc, int fr, int fq, LAS unsigned char*) const {
#pragma unroll
        for (int ai = 0; ai < 2; ++ai)
#pragma unroll
            for (int m = 0; m < 4; ++m) {
                const int row = u.pm * 256 + ai * 128 + wr * 64 + m * 16 + fr;
                const size_t off = (size_t)row * DM + u.pn * 256 + wc * 32 + 4 * fq;
                float s = 0.f;
#pragma unroll
                for (int bj = 0; bj < 2; ++bj)
#pragma unroll
                    for (int n = 0; n < 2; ++n) {
                        const f32x4 bs = *(const f32x4*)(base + off + bj * 128 + n * 16);
                        const f32x4 o = bs + acc[ai][bj][m][n];
                        *(f32x4*)(out + off + bj * 128 + n * 16) = o;
                        s += (o[0] * o[0] + o[1] * o[1]) + (o[2] * o[2] + o[3] * o[3]);
                        if (xb) { u32x2 w; w.x = cvt_pk_bf16(o[0], o[1]); w.y = cvt_pk_bf16(o[2], o[3]); *(u32x2*)(xb + off + bj * 128 + n * 16) = w; }
                    }
                s += __shfl_xor(s, 16); s += __shfl_xor(s, 32);
                if (fq == 0) atomicAdd(ss + row, s);
            }
    }
};
template <int ACT> struct EpiRowScale {
    static constexpr bool PERM = true;
    bf16_t* O; int ldc; const float* ss;
    DI void operator()(AccRef acc, const Unit& u, int wr, int wc, int fr, int fq, LAS unsigned char*) const {
#pragma unroll
        for (int ai = 0; ai < 2; ++ai)
#pragma unroll
            for (int m = 0; m < 4; ++m) {
                const int row = u.pm * 256 + ai * 128 + wr * 64 + m * 16 + fr;
                const float r = 1.0f / sqrtf(ss[row] * (1.0f / DM) + EPS);
                bf16_t* rowp = O + (size_t)row * ldc + u.pn * 256 + wc * 32 + 8 * fq;
#pragma unroll
                for (int bj = 0; bj < 2; ++bj) {
                    f32x4 v0 = acc[ai][bj][m][0] * r, v1 = acc[ai][bj][m][1] * r;
                    if (ACT == 1) {
#pragma unroll
                        for (int e = 0; e < 4; ++e) { const float a = fmaxf(v0[e], 0.f), b = fmaxf(v1[e], 0.f); v0[e] = a * a; v1[e] = b * b; }
                    }
                    u32x4 w; w.x = cvt_pk_bf16(v0[0], v0[1]); w.y = cvt_pk_bf16(v0[2], v0[3]); w.z = cvt_pk_bf16(v1[0], v1[1]); w.w = cvt_pk_bf16(v1[2], v1[3]);
                    *(u32x4*)(rowp + bj * 128) = w;
                }
            }
    }
};
struct EpiSoftmax {
    static constexpr bool PERM = true;
    bf16_t* PB; float* lrow;
    DI void operator()(AccRef acc, const Unit& u, int wr, int wc, int fr, int fq, LAS unsigned char* xlds) const {
        int rb = wr * 64 + fr; asm volatile("" : "+v"(rb));
        LAS float* red1 = (LAS float*)xlds + rb * 4; LAS float* red2 = (LAS float*)(xlds + 4096) + rb * 4;
        const float SC = 0.0625f * LOG2E;
#pragma unroll
        for (int ai = 0; ai < 2; ++ai)
#pragma unroll
            for (int m = 0; m < 4; ++m) {
                float a = -3.0e38f;
#pragma unroll
                for (int bj = 0; bj < 2; ++bj)
#pragma unroll
                    for (int n = 0; n < 2; ++n) { const f32x4 v = acc[ai][bj][m][n]; a = fmaxf(a, fmaxf(fmaxf(v[0], v[1]), fmaxf(v[2], v[3]))); }
                a = fmaxf(a, __shfl_xor(a, 16)); a = fmaxf(a, __shfl_xor(a, 32));
                if (fq == 0) red1[(ai * 128 + m * 16) * 4 + wc] = a;
            }
        LDS_WAIT(); __builtin_amdgcn_s_barrier(); asm volatile("" ::: "memory");
        bf16_t* pbase = PB + (size_t)(u.pm * 256 + rb) * DM + u.pn * 256 + wc * 32 + 8 * fq;
#pragma unroll
        for (int ai = 0; ai < 2; ++ai)
#pragma unroll
            for (int m = 0; m < 4; ++m) {
                const f32x4 rr = *(const LAS f32x4*)(red1 + (ai * 128 + m * 16) * 4);
                const float mxv = fmaxf(fmaxf(rr[0], rr[1]), fmaxf(rr[2], rr[3])) * SC;
                bf16_t* rowp = pbase + (size_t)(ai * 128 + m * 16) * DM;
                float s = 0.f;
#pragma unroll
                for (int bj = 0; bj < 2; ++bj) {
                    f32x4 v0 = acc[ai][bj][m][0], v1 = acc[ai][bj][m][1];
#pragma unroll
                    for (int e = 0; e < 4; ++e) { v0[e] = __builtin_amdgcn_exp2f(v0[e] * SC - mxv); v1[e] = __builtin_amdgcn_exp2f(v1[e] * SC - mxv); }
                    s += (v0[0] + v0[1]) + (v0[2] + v0[3]) + (v1[0] + v1[1]) + (v1[2] + v1[3]);
                    u32x4 w; w.x = cvt_pk_bf16(v0[0], v0[1]); w.y = cvt_pk_bf16(v0[2], v0[3]); w.z = cvt_pk_bf16(v1[0], v1[1]); w.w = cvt_pk_bf16(v1[2], v1[3]);
                    *(u32x4*)(rowp + bj * 128) = w;
                }
                s += __shfl_xor(s, 16); s += __shfl_xor(s, 32);
                if (fq == 0) red2[(ai * 128 + m * 16) * 4 + wc] = s;
                asm volatile("" ::: "memory");
            }
        LDS_WAIT(); __builtin_amdgcn_s_barrier(); asm volatile("" ::: "memory");
        if (wc == 0 && fq == 0) {
            float* lb = lrow + (size_t)(u.pm * 256 + rb) * 4 + u.pn;
#pragma unroll
            for (int ai = 0; ai < 2; ++ai)
#pragma unroll
                for (int m = 0; m < 4; ++m) { const f32x4 r = *(const LAS f32x4*)(red2 + (ai * 128 + m * 16) * 4);
                    lb[(size_t)(ai * 128 + m * 16) * 4] = (r[0] + r[1]) + (r[2] + r[3]); }
        }
    }
};
struct EpiPV {
    static constexpr bool PERM = true;
    bf16_t* O; const float* lrow;
    DI void operator()(AccRef acc, const Unit& u, int wr, int wc, int fr, int fq, LAS unsigned char*) const {
#pragma unroll
        for (int ai = 0; ai < 2; ++ai)
#pragma unroll
            for (int m = 0; m < 4; ++m) {
                const int row = u.pm * 256 + ai * 128 + wr * 64 + m * 16 + fr;
                const float r = 1.0f / lrow[(size_t)row * 4 + u.pn];
                bf16_t* rowp = O + (size_t)row * DM + u.pn * 256 + wc * 32 + 8 * fq;
#pragma unroll
                for (int bj = 0; bj < 2; ++bj) {
                    const f32x4 v0 = acc[ai][bj][m][0] * r, v1 = acc[ai][bj][m][1] * r;
                    u32x4 w; w.x = cvt_pk_bf16(v0[0], v0[1]); w.y = cvt_pk_bf16(v0[2], v0[3]); w.z = cvt_pk_bf16(v1[0], v1[1]); w.w = cvt_pk_bf16(v1[2], v1[3]);
                    *(u32x4*)(rowp + bj * 128) = w;
                }
            }
    }
};

typedef GAS unsigned gu32;
#define RLX_AGENT __ATOMIC_RELAXED, __HIP_MEMORY_SCOPE_AGENT
#define XB_TMO      128
#define XB_XCNT(j)  (256  + 64 * (j))
#define XB_XSUB(j)  (1280 + 64 * (j))
#define XB_XGEN(j)  (2304 + 64 * (j))
#define XB_TOP      3328
#define XB_TOPGEN   3392
#define XCD_BAR_WORDS 3456
#define XB_SPIN_CAP (1u << 18)
DI unsigned xb_ld(unsigned* p)              { return __hip_atomic_load(p, __ATOMIC_RELAXED, __HIP_MEMORY_SCOPE_AGENT); }
DI unsigned xb_add(unsigned* p, unsigned v) { return __hip_atomic_fetch_add(p, v, __ATOMIC_RELAXED, __HIP_MEMORY_SCOPE_AGENT); }
DI unsigned xb_xcc_id() { return (unsigned)__builtin_amdgcn_s_getreg((3 << 11) | 20) & 0xFu; }
#define XB_SPIN(cond, bar) do { unsigned _sp = 0; while (cond) { __builtin_amdgcn_s_sleep(1); \
    if ((++_sp & 255u) == 0u) { if (xb_ld(&(bar)[XB_TMO])) break; if (_sp > XB_SPIN_CAP) { atomicAdd(&(bar)[XB_TMO], 1u); break; } } } } while (0)
struct XcdBarrier { unsigned* bar; unsigned x; volatile LAS unsigned* st; };
DI XcdBarrier xcd_barrier_post(unsigned* bar, volatile LAS unsigned* st) {
    XcdBarrier b; b.bar = bar; b.x = xb_xcc_id(); b.st = st;
    if (threadIdx.x == 0) (void)xb_add(&bar[XB_XCNT(b.x)], 1u);
    return b;
}
DI void xcd_barrier_complete(unsigned* bar, unsigned x, unsigned& nloc, unsigned& nx) {
    const unsigned G = gridDim.x * gridDim.y * gridDim.z;
    unsigned sum, cnt, mine, sp = 0u;
    for (;;) {
        sum = 0u; cnt = 0u; mine = 0u;
#pragma unroll
        for (unsigned j = 0; j < 16; ++j) { const unsigned c = xb_ld(&bar[XB_XCNT(j)]); sum += c; cnt += (c > 0u) ? 1u : 0u; mine = (j == x) ? c : mine; }
        if (sum == G) break;
        __builtin_amdgcn_s_sleep(1);
        if ((++sp & 255u) == 0u) { if (xb_ld(&bar[XB_TMO])) break; if (sp > XB_SPIN_CAP) { atomicAdd(&bar[XB_TMO], 1u); break; } }
    }
    nloc = mine > 0u ? mine : 1u; nx = cnt > 0u ? cnt : 1u;
}
DI void xcd_barrier(const XcdBarrier& b) {
    asm volatile("s_waitcnt vmcnt(0)" ::: "memory");
    __syncthreads();
    if (threadIdx.x == 0) {
        unsigned* bar = b.bar;
        __builtin_amdgcn_s_waitcnt(0);
        unsigned nloc = b.st[0], nx = b.st[1];
        if (nloc == 0u) { xcd_barrier_complete(bar, b.x, nloc, nx); b.st[0] = nloc; b.st[1] = nx; }
        const unsigned old = xb_add(&bar[XB_XSUB(b.x)], 1u);
        const unsigned gen = old / nloc;
        if (old + 1u == (gen + 1u) * nloc) {
            __builtin_amdgcn_fence(__ATOMIC_RELEASE, "agent");
            asm volatile("s_waitcnt vmcnt(0)" ::: "memory");
            const unsigned og = xb_add(&bar[XB_TOP], 1u);
            const unsigned tg = og / nx;
            if (og + 1u == (tg + 1u) * nx) xb_add(&bar[XB_TOPGEN], 1u);
            else XB_SPIN(xb_ld(&bar[XB_TOPGEN]) == tg, bar);
            __builtin_amdgcn_fence(__ATOMIC_ACQUIRE, "agent");
            xb_add(&bar[XB_XGEN(b.x)], 1u);
            asm volatile("s_waitcnt vmcnt(0)" ::: "memory");
        } else {
            XB_SPIN(xb_ld(&bar[XB_XGEN(b.x)]) == gen, bar);
            __builtin_amdgcn_fence(__ATOMIC_ACQUIRE, "agent");
            asm volatile("s_waitcnt vmcnt(0)" ::: "memory");
        }
    }
    __syncthreads();
}

DI void p0_transpose_item(const float* W, int ld, int K, int N, bf16_t* WT, int row_off, const float* gain, LAS float* scr, int item, int lane) {
    const int nblk = N / 32, kb = item / nblk, nb = item % nblk, k0 = 64 * kb, n0 = 32 * nb;
#pragma unroll 8
    for (int i = 0; i < 32; ++i) { const int kk = 2 * i + (lane >> 5); float v = W[(size_t)(k0 + kk) * ld + n0 + (lane & 31)]; if (gain) v *= gain[k0 + kk]; scr[kk * 33 + (lane & 31)] = v; }
    LDS_WAIT(); asm volatile("" ::: "memory");
    const int c = lane & 7;
#pragma unroll
    for (int j = 0; j < 4; ++j) { const int n = (lane >> 3) + 8 * j; const LAS float* s = scr + (8 * c) * 33 + n;
        u32x4 o; o.x = pk2(s[0 * 33], s[1 * 33]); o.y = pk2(s[2 * 33], s[3 * 33]); o.z = pk2(s[4 * 33], s[5 * 33]); o.w = pk2(s[6 * 33], s[7 * 33]);
        *(GAS u32x4*)(WT + (size_t)(row_off + n0 + n) * K + k0 + 8 * c) = o; }
    LDS_WAIT(); asm volatile("" ::: "memory");
}
DI void rms_row_to_bf16(const float* xrow, const float* g, bf16_t* orow, int lane) {
    const GAS f32x4* xr = (const GAS f32x4*)xrow + lane; const GAS f32x4* gr = (const GAS f32x4*)g + lane;
    f32x4 v[4]; float s = 0.f;
#pragma unroll
    for (int j = 0; j < 4; ++j) { v[j] = xr[64 * j]; s += (v[j].x * v[j].x + v[j].y * v[j].y) + (v[j].z * v[j].z + v[j].w * v[j].w); }
    const float r = 1.0f / sqrtf(wave_sum(s) * (1.0f / DM) + EPS);
    GAS unsigned long long* o8 = (GAS unsigned long long*)orow + lane;
#pragma unroll
    for (int j = 0; j < 4; ++j) { const f32x4 gg = gr[64 * j]; o8[64 * j] = (unsigned long long)pk2(v[j].x * r * gg.x, v[j].y * r * gg.y) | ((unsigned long long)pk2(v[j].z * r * gg.z, v[j].w * r * gg.w) << 32); }
}

namespace dattn {
typedef short v4i16_t __attribute__((ext_vector_type(4)));
constexpr int OS_ROW = 136;
constexpr int OST_OFF = 0, ML_OFF = 512 * OS_ROW  , VST_OFF = ML_OFF + 4096  , RS = 144, VST_WAVE = 32 * RS  ;
static_assert(VST_OFF + 8 * VST_WAVE <= RING_BYTES, "dattn LDS");
DI int crow(int reg, int h) { return (reg & 3) + 8 * (reg >> 2) + 4 * h; }
DI s16x4 vtr(const LAS unsigned char* p) { return __builtin_bit_cast(s16x4, __builtin_amdgcn_ds_read_tr16_b64_v4i16((LAS v4i16_t*)p)); }

DI void task(LAS unsigned char* lds, const bf16_t* qkv, bf16_t* yfa, int b, int hs, int t0, int gi, int ti, int wid, int lane) {
    const int lg = gi * 2;
    const int nblk = 16 >> lg;
    const int r = ti / nblk, blk = ti % nblk;
    const int L = SEQ >> lg;
    const int J0 = (t0 >> lg) + blk * 32;
    const int head = gi * 4 + hs;
    const int ql = lane & 31, h = lane >> 5;
    const int tq = t0 + r + ((blk * 32 + ql) << lg);
    const int sidx = tq - t0;
    const bf16_t* qrow = qkv + (size_t)(b * SEQ + tq) * NQKV + head * 64 + h * 8;
    bf16x8 qf[4];
#pragma unroll
    for (int ks = 0; ks < 4; ++ks) qf[ks] = *(const bf16x8*)(qrow + ks * 16);
    LAS unsigned char* ost = lds + OST_OFF + sidx * OS_ROW;
    LAS float* ml = (LAS float*)(lds + ML_OFF) + sidx * 2;
    LAS unsigned char* vst = lds + VST_OFF + wid * VST_WAVE;
    float m_run = -1.0e30f, l_run = 0.f;
    f32x16 o0, o1;
#pragma unroll
    for (int i = 0; i < 16; ++i) { o0[i] = 0.f; o1[i] = 0.f; }
    if (gi > 0) {
        m_run = ml[0]; l_run = ml[1];
#pragma unroll
        for (int g = 0; g < 4; ++g) {
            const u32x2 a = *(const LAS u32x2*)(ost + (8 * g + 4 * h) * 2);
            const u32x2 c = *(const LAS u32x2*)(ost + (32 + 8 * g + 4 * h) * 2);
            o0[4 * g] = bflo(a.x); o0[4 * g + 1] = bfhi(a.x); o0[4 * g + 2] = bflo(a.y); o0[4 * g + 3] = bfhi(a.y);
            o1[4 * g] = bflo(c.x); o1[4 * g + 1] = bfhi(c.x); o1[4 * g + 2] = bflo(c.y); o1[4 * g + 3] = bfhi(c.y);
        }
    }
    const float SC = 0.125f * LOG2E;
    const int i16 = lane & 15, q4 = i16 >> 2, p4 = i16 & 3, b16 = (lane >> 4) & 1;
    const LAS unsigned char* trbase = vst + (4 * h + q4) * RS + (16 * b16 + 4 * p4) * 2;
    const bf16_t* kvbase = qkv + (size_t)(b * SEQ + r) * NQKV + head * 64;
#pragma unroll 1
    for (int c = 0; c < 5; ++c) {
        const int jb = J0 - 64 + 32 * c;
        int jk = jb + ql; jk = jk < 0 ? 0 : (jk >= L ? L - 1 : jk);
        const bf16_t* krow = kvbase + (size_t)(jk << lg) * NQKV + 768 + h * 8;
        bf16x8 kf[4];
#pragma unroll
        for (int ks = 0; ks < 4; ++ks) kf[ks] = *(const bf16x8*)(krow + ks * 16);
        u32x4 vr[4];
#pragma unroll
        for (int i = 0; i < 4; ++i) { int jv = jb + (lane >> 3) + 8 * i; jv = jv < 0 ? 0 : (jv >= L ? L - 1 : jv);
            vr[i] = *(const u32x4*)(kvbase + (size_t)(jv << lg) * NQKV + 1536 + (lane & 7) * 8); }
        asm volatile("" ::: "memory");
#pragma unroll
        for (int i = 0; i < 4; ++i) *(LAS u32x4*)(vst + ((lane >> 3) + 8 * i) * RS + (lane & 7) * 16) = vr[i];
        f32x16 st;
#pragma unroll
        for (int i = 0; i < 16; ++i) st[i] = 0.f;
#pragma unroll
        for (int ks = 0; ks < 4; ++ks) st = __builtin_amdgcn_mfma_f32_32x32x16_bf16(kf[ks], qf[ks], st, 0, 0, 0);
        float cmax = -INFINITY;
#pragma unroll
        for (int i = 0; i < 16; ++i) {
            const int kk = crow(i, h); const int jkk = jb + kk; const int rel = jkk - (J0 + ql);
            const bool valid = (rel >= -64) && (rel <= 64) && (jkk >= 0) && (jkk < L);
            st[i] = valid ? st[i] * SC : -INFINITY;
            cmax = fmaxf(cmax, st[i]);
        }
        cmax = fmaxf(cmax, __shfl_xor(cmax, 32));
        const float mnew = fmaxf(m_run, cmax);
        const float alpha = __builtin_amdgcn_exp2f(m_run - mnew);
        float psum = 0.f;
#pragma unroll
        for (int i = 0; i < 16; ++i) { st[i] = __builtin_amdgcn_exp2f(st[i] - mnew); psum += st[i]; }
        psum += __shfl_xor(psum, 32);
        l_run = l_run * alpha + psum; m_run = mnew;
#pragma unroll
        for (int i = 0; i < 16; ++i) { o0[i] *= alpha; o1[i] *= alpha; }
        u32x4 pa, pb;
        pa.x = pk2(st[0], st[1]); pa.y = pk2(st[2], st[3]); pa.z = pk2(st[4], st[5]); pa.w = pk2(st[6], st[7]);
        pb.x = pk2(st[8], st[9]); pb.y = pk2(st[10], st[11]); pb.z = pk2(st[12], st[13]); pb.w = pk2(st[14], st[15]);
        const bf16x8 pf0 = __builtin_bit_cast(bf16x8, pa), pf1 = __builtin_bit_cast(bf16x8, pb);
        asm volatile("" ::: "memory");
#pragma unroll
        for (int blk2 = 0; blk2 < 2; ++blk2) {
            const s16x4 lo0 = vtr(trbase + blk2 * 64), hi0 = vtr(trbase + 8 * RS + blk2 * 64);
            const s16x4 lo1 = vtr(trbase + 16 * RS + blk2 * 64), hi1 = vtr(trbase + 24 * RS + blk2 * 64);
            const bf16x8 va0 = __builtin_shufflevector(lo0, hi0, 0, 1, 2, 3, 4, 5, 6, 7), va1 = __builtin_shufflevector(lo1, hi1, 0, 1, 2, 3, 4, 5, 6, 7);
            if (blk2 == 0) { o0 = __builtin_amdgcn_mfma_f32_32x32x16_bf16(va0, pf0, o0, 0, 0, 0); o0 = __builtin_amdgcn_mfma_f32_32x32x16_bf16(va1, pf1, o0, 0, 0, 0); }
            else { o1 = __builtin_amdgcn_mfma_f32_32x32x16_bf16(va0, pf0, o1, 0, 0, 0); o1 = __builtin_amdgcn_mfma_f32_32x32x16_bf16(va1, pf1, o1, 0, 0, 0); }
        }
        asm volatile("" ::: "memory");
    }
    if (gi < 2) {
        if (h == 0) { ml[0] = m_run; ml[1] = l_run; }
#pragma unroll
        for (int g = 0; g < 4; ++g) {
            u32x2 a, c; a.x = pk2(o0[4 * g], o0[4 * g + 1]); a.y = pk2(o0[4 * g + 2], o0[4 * g + 3]); c.x = pk2(o1[4 * g], o1[4 * g + 1]); c.y = pk2(o1[4 * g + 2], o1[4 * g + 3]);
            *(LAS u32x2*)(ost + (8 * g + 4 * h) * 2) = a; *(LAS u32x2*)(ost + (32 + 8 * g + 4 * h) * 2) = c;
        }
    } else {
        const float rl = 1.0f / l_run;
        bf16_t* yrow = yfa + (size_t)(b * SEQ + tq) * 512 + 256 + hs * 64;
#pragma unroll
        for (int g = 0; g < 4; ++g) {
            u32x2 a, c; a.x = pk2(o0[4 * g] * rl, o0[4 * g + 1] * rl); a.y = pk2(o0[4 * g + 2] * rl, o0[4 * g + 3] * rl);
            c.x = pk2(o1[4 * g] * rl, o1[4 * g + 1] * rl); c.y = pk2(o1[4 * g + 2] * rl, o1[4 * g + 3] * rl);
            *(u32x2*)(yrow + 8 * g + 4 * h) = a; *(u32x2*)(yrow + 32 + 8 * g + 4 * h) = c;
        }
    }
}
DI void unit(LAS unsigned char* lds, const bf16_t* qkv, bf16_t* yfa, int uid, int wid, int lane) {
    const int b = uid >> 4, hs = (uid >> 2) & 3, t0 = (uid & 3) * 512;
#pragma unroll 1
    for (int gi = 0; gi < 3; ++gi) {
#pragma unroll 1
        for (int rd = 0; rd < 2; ++rd) task(lds, qkv, yfa, b, hs, t0, gi, rd * 8 + wid, wid, lane);
        __syncthreads();
    }
}
}

struct Args { const float* in[17]; float* out; unsigned char* ws; int ph_lo, ph_hi, li, pad; };
constexpr int NPH = 13;

__global__ void __launch_bounds__(NWAVES * 64, 2) mk_fwd(Args args) {
    extern __shared__ __attribute__((aligned(16))) unsigned char lds_raw[];
    LAS unsigned char* lds = (LAS unsigned char*)lds_raw;
    LAS unsigned char* xlds = lds + XLDS_OFF;
    volatile LAS unsigned* MISC = (volatile LAS unsigned*)(lds + MISC_OFF);
    const int tid = threadIdx.x, wave = __builtin_amdgcn_readfirstlane(tid >> 6);
    const int G = gridDim.x, bx = blockIdx.x;
    unsigned char* ws = args.ws;
    gu32* ctl = (gu32*)(ws + WS_CTL);
    const float* x = args.in[0]; const float* mem = args.in[1]; const float* norm_mix = args.in[2]; const float* w_in = args.in[3]; const float* fmix = args.in[4];
    const float* w_fb = args.in[5]; const float* w_ab = args.in[6]; const float* w_mix = args.in[7]; const float* norm_cross = args.in[8]; const float* norm_mem = args.in[9];
    const float* w_cq = args.in[10]; const float* w_ckv = args.in[11]; const float* w_co = args.in[12]; const float* norm_mlp = args.in[13]; const float* w_up = args.in[14];
    const float* w_down = args.in[15]; const float* norm_final = args.in[16];
    float* out = args.out;
    bf16_t* Win_t = (bf16_t*)(ws + WS_WIN); bf16_t* Wfb_t = (bf16_t*)(ws + WS_WFB); bf16_t* Wab_t = (bf16_t*)(ws + WS_WAB); bf16_t* Wmix_t = (bf16_t*)(ws + WS_WMIX);
    bf16_t* Wcq_t = (bf16_t*)(ws + WS_WCQ); bf16_t* Wckv_t = (bf16_t*)(ws + WS_WCKV); bf16_t* Wco_t = (bf16_t*)(ws + WS_WCO); bf16_t* Wup_t = (bf16_t*)(ws + WS_WUP); bf16_t* Wdn_t = (bf16_t*)(ws + WS_WDN);
    bf16_t* CCAT = (bf16_t*)(ws + WS_CCAT); bf16_t* MEMN = (bf16_t*)(ws + WS_MEMN); bf16_t* XN = (bf16_t*)(ws + WS_XN); bf16_t* X1 = (bf16_t*)(ws + WS_X1);
    bf16_t* YFA = (bf16_t*)(ws + WS_YFA); bf16_t* X2 = (bf16_t*)(ws + WS_X2); bf16_t* QKV = (bf16_t*)(ws + WS_QKV); bf16_t* TMP = (bf16_t*)(ws + WS_TMP);
    bf16_t* MERGED = (bf16_t*)(ws + WS_MERGED); bf16_t* QC = (bf16_t*)(ws + WS_QC); bf16_t* PB = (bf16_t*)(ws + WS_PB); bf16_t* OB = (bf16_t*)(ws + WS_O);
    bf16_t* GATES = (bf16_t*)(ws + WS_GATES); bf16_t* PT = (bf16_t*)(ws + WS_PT); bf16_t* KC = (bf16_t*)(ws + WS_KC); bf16_t* VCT = (bf16_t*)(ws + WS_VCT); bf16_t* HID = (bf16_t*)(ws + WS_HID);
    float* ROPEC = (float*)(ws + WS_ROPEC); float* ROPES = (float*)(ws + WS_ROPES); float* LROW = (float*)(ws + WS_LROW);
    float* SS1 = (float*)(ws + WS_SS); float* SS2 = SS1 + T; float* SS3 = SS2 + T;

    for (int u = tid; u < (LDS_BYTES - LDSCTL_OFF) / 4; u += NWAVES * 64) ((LAS unsigned*)(lds + LDSCTL_OFF))[u] = 0u;
    __syncthreads();
    XcdBarrier bar; bar.bar = (unsigned*)(ctl + CW_BAR); bar.x = 0; bar.st = nullptr;
    if (MK_N_LAUNCHES == 1) bar = xcd_barrier_post((unsigned*)(ctl + CW_BAR), MISC + 8);
#define GRID_BAR() do { if (MK_N_LAUNCHES == 1) xcd_barrier(bar); } while (0)
    const int lo = args.ph_lo, hi = args.ph_hi;
#ifndef PH_MASK
#define PH_MASK 0x1fff
#endif
#define IN(k) (((PH_MASK >> (k)) & 1) && lo <= (k) && (k) < hi)
#define SEAM(k) do { if (IN(k) && IN((k) + 1)) GRID_BAR(); } while (0)

    if (IN(0)) {
        const int gw = bx * NWAVES + wave, NGW = G * NWAVES; const int lane = lane_id();
        {
            LAS float* scr = (LAS float*)(lds + wave * 16384);
            constexpr int I_IN = (DM / 64) * (NIN / 32), I_B = (256 / 64) * (DM / 32), I_SQ = (DM / 64) * (DM / 32), I_KV = (DM / 64) * (2048 / 32), I_UP = (DM / 64) * (FF / 32), I_DN = (FF / 64) * (DM / 32);
            constexpr int NITEMS = I_IN + 2 * I_B + 3 * I_SQ + I_KV + I_UP + I_DN;
            for (int it = gw; it < NITEMS; it += NGW) {
                int r = it;
                if (r < I_IN) { p0_transpose_item(w_in + 256, INW, DM, NIN, Win_t, NPF, nullptr, scr, r, lane); continue; } r -= I_IN;
                if (r < I_B) { p0_transpose_item(w_fb, DM, 256, DM, Wfb_t, 0, nullptr, scr, r, lane); continue; } r -= I_B;
                if (r < I_B) { p0_transpose_item(w_ab, DM, 256, DM, Wab_t, 0, nullptr, scr, r, lane); continue; } r -= I_B;
                if (r < I_SQ) { p0_transpose_item(w_mix, DM, DM, DM, Wmix_t, 0, nullptr, scr, r, lane); continue; } r -= I_SQ;
                if (r < I_SQ) { p0_transpose_item(w_cq, DM, DM, DM, Wcq_t, 0, norm_cross, scr, r, lane); continue; } r -= I_SQ;
                if (r < I_SQ) { p0_transpose_item(w_co, DM, DM, DM, Wco_t, 0, nullptr, scr, r, lane); continue; } r -= I_SQ;
                if (r < I_KV) { p0_transpose_item(w_ckv, 2048, DM, 2048, Wckv_t, 0, nullptr, scr, r, lane); continue; } r -= I_KV;
                if (r < I_UP) { p0_transpose_item(w_up, FF, DM, FF, Wup_t, 0, norm_mlp, scr, r, lane); continue; } r -= I_UP;
                p0_transpose_item(w_down, DM, FF, DM, Wdn_t, 0, nullptr, scr, r, lane);
            }
        }
        __syncthreads();
        {
            LAS float* ctab = (LAS float*)lds;
            for (int i = tid; i < SEQ; i += NWAVES * 64) ctab[i] = cospif((float)i * (1.0f / 1024.0f)) * 0.022097086912079608f;
            __syncthreads();
            for (int sp = gw; sp < SEQ; sp += NGW) {
#pragma unroll 1
                for (int j = 0; j < 8; ++j) {
                    const int k0 = 8 * (lane + 64 * j);
                    float v[8];
#pragma unroll
                    for (int e = 0; e < 8; ++e) { const int k = k0 + e, s = k & (SEQ - 1); const int mm = (sp * s) & (SEQ - 1); v[e] = (k < SEQ) ? ctab[mm] : -ctab[(mm - 512) & (SEQ - 1)]; }
                    u32x4 o; o.x = pk2(v[0], v[1]); o.y = pk2(v[2], v[3]); o.z = pk2(v[4], v[5]); o.w = pk2(v[6], v[7]);
                    *(GAS u32x4*)(CCAT + (size_t)sp * 4096 + k0) = o;
                }
            }
            __syncthreads();
        }
        for (int id = bx; id < 128; id += G) {
            const int part = id >> 6, g = (id >> 4) & 3, k0 = (id & 15) * 64;
            LAS float* Fs = (LAS float*)lds; LAS float* Ms = (LAS float*)(lds + 16384); LAS float* Ws = (LAS float*)(lds + 16384 + 64 * 65 * 4); LAS float* tr64 = (LAS float*)(lds + 16384 + 2 * 64 * 65 * 4);
#pragma unroll
            for (int i = 0; i < 8; ++i) { const int idx = tid + 512 * i; Fs[idx] = fmix[(size_t)g * 4096 + idx]; const int kk = idx >> 6, c = idx & 63; Ws[kk * 65 + c] = w_in[(size_t)(k0 + kk) * INW + g * 64 + c]; }
            if (tid < 64) tr64[tid] = cospif((float)tid * (1.0f / 32.0f)) * 0.125f;
            __syncthreads();
            { const int d = tid & 63;
#pragma unroll 1
              for (int i = 0; i < 8; ++i) { const int c = (tid >> 6) + 8 * i; float a = 0.f;
                  for (int cp = 0; cp < 64; ++cp) { const int mm = (c * cp) & 63; const float tv = part == 0 ? tr64[mm] : tr64[(mm + 48) & 63]; a += tv * Fs[cp * 64 + d]; }
                  Ms[c * 65 + d] = a; } }
            __syncthreads();
            { const int d = tid >> 3, kk0 = (tid & 7) * 8; float a[8];
#pragma unroll
              for (int j = 0; j < 8; ++j) a[j] = 0.f;
              for (int c = 0; c < 64; ++c) { const float mv = Ms[c * 65 + d];
#pragma unroll
                  for (int j = 0; j < 8; ++j) a[j] += Ws[(kk0 + j) * 65 + c] * mv; }
              u32x4 o; o.x = pk2(a[0], a[1]); o.y = pk2(a[2], a[3]); o.z = pk2(a[4], a[5]); o.w = pk2(a[6], a[7]);
              *(GAS u32x4*)(Win_t + (size_t)(part * 256 + g * 64 + d) * DM + k0 + kk0) = o; }
            __syncthreads();
        }
        for (int i = bx * 512 + tid; i < SEQ * 8; i += G * 512) { const int pos = i >> 3, f = i & 7; const float inv = powf(500000.0f, -(float)f / 8.0f); const float ang = (float)pos * inv; float sn, cs; sincosf(ang, &sn, &cs); ROPEC[i] = cs; ROPES[i] = sn; }
        for (int m = gw; m < T; m += NGW) rms_row_to_bf16(x + (size_t)m * DM, norm_mix, XN + (size_t)m * DM, lane);
        for (int m = gw; m < MEMT; m += NGW) rms_row_to_bf16(mem + (size_t)m * DM, norm_mem, MEMN + (size_t)m * DM, lane);
    }
    SEAM(0);
    if (IN(1)) {
        { SchedPlain S; S.init(XN, DM, Win_t + (size_t)NPF * DM, DM, T / 256, NIN / 256, G, bx); EpiIn E{QKV, GATES, ROPEC, ROPES};
          pg8::gemm_phase<EpiIn, SchedPlain, true>(lds, xlds, DM, DM, DM, S, E); }
        { SchedPlain S; S.init(Win_t, DM, XN, DM, NPF / 256, T / 256, G, bx); EpiPt E{PT};
          pg8::gemm_phase<EpiPt, SchedPlain, true>(lds, xlds, DM, DM, DM, S, E); }
        { SchedPlain S; S.init(MEMN, DM, Wckv_t, DM, MEMT / 256, DM / 256, G, (bx + 128) % G); EpiPlain E{KC, DM};
          pg8::gemm_phase<EpiPlain, SchedPlain, true>(lds, xlds, DM, DM, DM, S, E); }
        { SchedPlain S; S.init(Wckv_t + (size_t)DM * DM, DM, MEMN, DM, DM / 256, MEMT / 256, G, (bx + 192) % G); EpiPlain E{VCT, MEMT};
          pg8::gemm_phase<EpiPlain, SchedPlain, true>(lds, xlds, DM, DM, DM, S, E); }
    }
    SEAM(1);
    if (IN(2)) {
        if (bx < 128) {
            SchedDft S{(const char*)CCAT, (const char*)PT, bx}; EpiPlain E{YFA, 512};
            pg8::gemm_phase<EpiPlain, SchedDft, true>(lds, xlds, 4096, 4096, 4096, S, E);
        } else {
            const int lane = lane_id();
            for (int uid = bx - 128; uid < 256; uid += (G - 128)) dattn::unit(lds, QKV, YFA, uid, wave, lane);
        }
    }
    SEAM(2);
    if (IN(3)) { SchedPlain S; S.init(YFA, 512, Wfb_t, 256, T / 256, DM / 256, G, bx); EpiGate<0> E{TMP, nullptr, GATES, 0};
        pg8::gemm_phase<EpiGate<0>, SchedPlain, true>(lds, xlds, 256, 512, 256, S, E); }
    SEAM(3);
    if (IN(4)) { SchedPlain S; S.init(YFA + 256, 512, Wab_t, 256, T / 256, DM / 256, G, bx); EpiGate<1> E{MERGED, TMP, GATES, 1024};
        pg8::gemm_phase<EpiGate<1>, SchedPlain, true>(lds, xlds, 256, 512, 256, S, E); }
    SEAM(4);
    if (IN(5)) { SchedPlain S; S.init(MERGED, DM, Wmix_t, DM, T / 256, DM / 256, G, bx); EpiRes E{x, out, X1, SS1};
        pg8::gemm_phase<EpiRes, SchedPlain, true>(lds, xlds, DM, DM, DM, S, E); }
    SEAM(5);
    if (IN(6)) { SchedPlain S; S.init(X1, DM, Wcq_t, DM, T / 256, DM / 256, G, bx); EpiRowScale<0> E{QC, DM, SS1};
        pg8::gemm_phase<EpiRowScale<0>, SchedPlain, true>(lds, xlds, DM, DM, DM, S, E); }
    SEAM(6);
    if (IN(7)) { SchedXS S; S.o.init(T / 256, 4, G, bx); S.QC = (const char*)QC; S.KC = (const char*)KC; EpiSoftmax E{PB, LROW};
        pg8::gemm_phase<EpiSoftmax, SchedXS, true>(lds, xlds, 256, DM, DM, S, E); }
    SEAM(7);
    if (IN(8)) { SchedXV S; S.o.init(T / 256, 4, G, bx); S.PB = (const char*)PB; S.VT = (const char*)VCT; EpiPV E{OB, LROW};
        pg8::gemm_phase<EpiPV, SchedXV, true>(lds, xlds, 256, DM, MEMT, S, E); }
    SEAM(8);
    if (IN(9)) { SchedPlain S; S.init(OB, DM, Wco_t, DM, T / 256, DM / 256, G, bx); EpiRes E{out, out, X2, SS2};
        pg8::gemm_phase<EpiRes, SchedPlain, true>(lds, xlds, DM, DM, DM, S, E); }
    SEAM(9);
    if (IN(10)) { SchedPlain S; S.init(X2, DM, Wup_t, DM, T / 256, FF / 256, G, bx); EpiRowScale<1> E{HID, FF, SS2};
        pg8::gemm_phase<EpiRowScale<1>, SchedPlain, true>(lds, xlds, DM, DM, DM, S, E); }
    SEAM(10);
    if (IN(11)) { SchedPlain S; S.init(HID, FF, Wdn_t, FF, T / 256, DM / 256, G, bx); EpiRes E{out, out, nullptr, SS3};
        pg8::gemm_phase<EpiRes, SchedPlain, true>(lds, xlds, FF, FF, FF, S, E); }
    SEAM(11);
    if (IN(12)) {
        const int gw = bx * NWAVES + wave, NGW = G * NWAVES; const int lane = lane_id();
        for (int m = gw; m < T; m += NGW) {
            const float r = 1.0f / sqrtf(__hip_atomic_load(SS3 + m, RLX_AGENT) * (1.0f / DM) + EPS);
            GAS f32x4* xr = (GAS f32x4*)(out + (size_t)m * DM) + lane; const GAS f32x4* gr = (const GAS f32x4*)norm_final + lane;
#pragma unroll
            for (int j = 0; j < 4; ++j) { const f32x4 v = xr[64 * j], gg = gr[64 * j]; xr[64 * j] = v * r * gg; }
        }
    }
#undef IN
#undef SEAM
#undef GRID_BAR
}

extern "C" void kernel_launch(void* const* d_in, const int* in_sizes, int n_in, void* d_out, int out_size, void* d_ws, size_t ws_size, hipStream_t stream) {
    static int grid = 0;
    if (grid == 0) {
        if (n_in != 17 || in_sizes[0] != T * DM || out_size != T * DM || ws_size < WS_END) { fprintf(stderr, "kernel_launch: unexpected shapes (n_in %d, in0 %d, out %d, ws %zu); nothing launched\n", n_in, n_in > 0 ? in_sizes[0] : -1, out_size, ws_size); grid = -1; return; }
        int dev = 0, cus = 0, per_cu = 0;
        if (hipGetDevice(&dev) != hipSuccess || hipDeviceGetAttribute(&cus, hipDeviceAttributeMultiprocessorCount, dev) != hipSuccess) { grid = -1; return; }
        if (hipFuncSetAttribute((const void*)mk_fwd, hipFuncAttributeMaxDynamicSharedMemorySize, LDS_BYTES) != hipSuccess) { fprintf(stderr, "kernel_launch: hipFuncSetAttribute failed\n"); grid = -1; return; }
        if (hipOccupancyMaxActiveBlocksPerMultiprocessor(&per_cu, (const void*)mk_fwd, NWAVES * 64, LDS_BYTES) != hipSuccess || per_cu < 1) fprintf(stderr, "kernel_launch: occupancy query reports %d\n", per_cu);
        (void)hipGetLastError();
        grid = cus;
        if (grid != 256) fprintf(stderr, "kernel_launch: %d CUs (built for 256)\n", grid);
    }
    if (grid < 0) return;
    (void)hipMemsetAsync((char*)d_ws + WS_CTL, 0, CTL_ZERO_BYTES, stream);
    Args a{};
    for (int i = 0; i < 17; ++i) a.in[i] = (const float*)d_in[i];
    a.out = (float*)d_out; a.ws = (unsigned char*)d_ws;
    for (int li = 0; li < MK_N_LAUNCHES; ++li) {
        a.ph_lo = (MK_N_LAUNCHES == 1) ? 0 : li; a.ph_hi = (MK_N_LAUNCHES == 1) ? NPH : li + 1; a.li = li;
        hipLaunchKernelGGL(mk_fwd, dim3(grid), dim3(NWAVES * 64), LDS_BYTES, stream, a);
    }
}
```
